# Optimizing an MI355X kernel written in HIP

```python
import jax, jax.numpy as jnp
from jax import lax
import numpy as np

D_MODEL = 1024
BATCH = 2
SEQ = 8192
DEPTH = 1

D_MIX = D_MODEL
CONF_WIDTH = D_MIX // 2
CONF_HEADS = 8
SCONV_WIDTH = D_MIX - CONF_WIDTH
SCONV_HEADS = 8
CONF_KERNEL = 31
SCONV_KERNEL = 3
D_IN = 2 * CONF_WIDTH + 3 * SCONV_WIDTH
N_GROUPS = 4
EXPERTS_PER_GROUP = 4
N_EXPERTS = N_GROUPS * EXPERTS_PER_GROUP
TOP_K_IN_GROUP = 2
D_EXPERT = 256
D_PLE = 256
LN_EPS = 1e-5
ALPHA = (2.0 * DEPTH) ** 0.25
BETA = (8.0 * DEPTH) ** -0.25

kernel_name = "hybrid_conformer_shortconv_hiermoe_deepnorm"


def layer_norm(x, g, b):
    xf = x.astype(jnp.float32)
    mu = jnp.mean(xf, axis=-1, keepdims=True)
    var = jnp.mean(jnp.square(xf - mu), axis=-1, keepdims=True)
    y = (xf - mu) * lax.rsqrt(var + LN_EPS) * g.astype(jnp.float32) + b.astype(jnp.float32)
    return y.astype(x.dtype)


def causal_depthwise_conv(u, w, b):
    k = w.shape[0]
    y = lax.conv_general_dilated(
        u, w[:, None, :].astype(u.dtype), window_strides=(1,), padding=[(k - 1, 0)],
        dimension_numbers=("NWC", "WIO", "NWC"), feature_group_count=u.shape[-1])
    return y + b


def hybrid_mixer(x, w_in, b_in, conf_dw_w, conf_dw_b, conf_ln_g, conf_ln_b, sc_w, sc_b, w_out, b_out):
    h = x @ w_in + b_in
    splits = [CONF_WIDTH, 2 * CONF_WIDTH, 2 * CONF_WIDTH + SCONV_WIDTH, 2 * CONF_WIDTH + 2 * SCONV_WIDTH]
    a_val, a_gate, b_gate, c_gate, v = jnp.split(h, splits, axis=-1)
    a = a_val * jax.nn.sigmoid(a_gate)
    a = causal_depthwise_conv(a, conf_dw_w, conf_dw_b)
    a = jax.nn.silu(layer_norm(a, conf_ln_g, conf_ln_b))
    s = b_gate * causal_depthwise_conv(c_gate * v, sc_w, sc_b)
    return jnp.concatenate([a, s], axis=-1) @ w_out + b_out


def hierarchical_moe(x, w_rg, b_rg, w_re, b_re, w_gate, w_up, w_down):
    bsz, t, d = x.shape
    xt = x.reshape(bsz * t, d)
    g_probs = jax.nn.softmax((xt @ w_rg + b_rg).astype(jnp.float32), axis=-1)
    g_p, g_idx = lax.top_k(g_probs, 1)
    e_logits_all = (xt @ w_re + b_re).astype(jnp.float32).reshape(-1, N_GROUPS, EXPERTS_PER_GROUP)
    e_logits = jnp.take_along_axis(e_logits_all, g_idx[:, :, None], axis=1)[:, 0]
    e_p, e_idx = lax.top_k(jax.nn.softmax(e_logits, axis=-1), TOP_K_IN_GROUP)
    e_p = e_p / jnp.sum(e_p, axis=-1, keepdims=True)
    weights = g_p * e_p
    expert_ids = g_idx * EXPERTS_PER_GROUP + e_idx
    combine = jnp.sum(jax.nn.one_hot(expert_ids, N_EXPERTS, dtype=jnp.float32) * weights[..., None], axis=1)
    combine = combine.astype(x.dtype)
    hg = jnp.einsum("nd,edf->nef", xt, w_gate)
    hu = jnp.einsum("nd,edf->nef", xt, w_up)
    hidden = jax.nn.silu(hg) * hu * combine[:, :, None]
    y = jnp.einsum("nef,efd->nd", hidden, w_down)
    return y.reshape(bsz, t, d)


def setup_inputs(seed: int = 0) -> dict:
    key = jax.random.key(seed)
    ks = jax.random.split(key, 32)
    f32 = jnp.float32
    nrm = lambda k, shape, s: jax.random.normal(k, shape, f32) * s
    L = DEPTH
    return {
        "x": nrm(ks[0], (BATCH, SEQ, D_MODEL), 1.0),
        "p": nrm(ks[1], (DEPTH, BATCH, SEQ, D_PLE), 1.0),
        "ln_in_g": 1.0 + nrm(ks[2], (D_MODEL,), 0.02),
        "ln_in_b": nrm(ks[3], (D_MODEL,), 0.02),
        "w_in": nrm(ks[4], (L, D_MODEL, D_IN), D_MODEL ** -0.5),
        "b_in": nrm(ks[5], (L, D_IN), 0.02),
        "conf_dw_w": nrm(ks[6], (L, CONF_KERNEL, CONF_WIDTH), CONF_KERNEL ** -0.5),
        "conf_dw_b": nrm(ks[7], (L, CONF_WIDTH), 0.02),
        "conf_ln_g": 1.0 + nrm(ks[8], (L, CONF_WIDTH), 0.02),
        "conf_ln_b": nrm(ks[9], (L, CONF_WIDTH), 0.02),
        "sc_w": nrm(ks[10], (L, SCONV_KERNEL, SCONV_WIDTH), SCONV_KERNEL ** -0.5),
        "sc_b": nrm(ks[11], (L, SCONV_WIDTH), 0.02),
        "w_out": nrm(ks[12], (L, D_MIX, D_MODEL), BETA * D_MIX ** -0.5),
        "b_out": nrm(ks[13], (L, D_MODEL), 0.02),
        "ln1_g": 1.0 + nrm(ks[14], (L, D_MODEL), 0.02),
        "ln1_b": nrm(ks[15], (L, D_MODEL), 0.02),
        "w_rg": nrm(ks[16], (L, D_MODEL, N_GROUPS), D_MODEL ** -0.5),
        "b_rg": nrm(ks[17], (L, N_GROUPS), 0.01),
        "w_re": nrm(ks[18], (L, D_MODEL, N_EXPERTS), D_MODEL ** -0.5),
        "b_re": nrm(ks[19], (L, N_EXPERTS), 0.01),
        "w_gate": nrm(ks[20], (L, N_EXPERTS, D_MODEL, D_EXPERT), D_MODEL ** -0.5),
        "w_up": nrm(ks[21], (L, N_EXPERTS, D_MODEL, D_EXPERT), D_MODEL ** -0.5),
        "w_down": nrm(ks[22], (L, N_EXPERTS, D_EXPERT, D_MODEL), BETA * D_EXPERT ** -0.5),
        "w_pg": nrm(ks[23], (L, D_MODEL, D_MODEL), D_MODEL ** -0.5),
        "b_pg": nrm(ks[24], (L, D_MODEL), 0.02),
        "w_pp": nrm(ks[25], (L, D_PLE, D_MODEL), BETA * D_PLE ** -0.5),
        "ln2_g": 1.0 + nrm(ks[26], (L, D_MODEL), 0.02),
        "ln2_b": nrm(ks[27], (L, D_MODEL), 0.02),
    }


def reference(x, p, ln_in_g, ln_in_b, w_in, b_in, conf_dw_w, conf_dw_b, conf_ln_g, conf_ln_b,
              sc_w, sc_b, w_out, b_out, ln1_g, ln1_b, w_rg, b_rg, w_re, b_re,
              w_gate, w_up, w_down, w_pg, b_pg, w_pp, ln2_g, ln2_b):
    x = layer_norm(x, ln_in_g, ln_in_b)
    for i in range(DEPTH):
        mix = hybrid_mixer(x, w_in[i], b_in[i], conf_dw_w[i], conf_dw_b[i], conf_ln_g[i], conf_ln_b[i],
                           sc_w[i], sc_b[i], w_out[i], b_out[i])
        x = layer_norm(ALPHA * x + mix, ln1_g[i], ln1_b[i])
        r = ALPHA * x + hierarchical_moe(x, w_rg[i], b_rg[i], w_re[i], b_re[i], w_gate[i], w_up[i], w_down[i])
        gate = jax.nn.sigmoid(r @ w_pg[i] + b_pg[i])
        x = layer_norm(r + gate * (p[i] @ w_pp[i]), ln2_g[i], ln2_b[i])
    return x
```

```cpp
#include <hip/hip_runtime.h>
#include <cstdio>
#include <cstdint>

#define LAS __attribute__((address_space(3)))
#define GAS __attribute__((address_space(1)))
typedef unsigned short bf16_t;
typedef short bf16x8 __attribute__((ext_vector_type(8)));
typedef float f32x4 __attribute__((ext_vector_type(4)));
typedef float f32x2 __attribute__((ext_vector_type(2)));
typedef unsigned u32x4 __attribute__((ext_vector_type(4)));
typedef unsigned u32x2 __attribute__((ext_vector_type(2)));

constexpr int M = 16384, D = 1024, SEQ = 8192, DIN = 2560, CW = 512, NEXP = 16, DEXP = 256, DPLE = 256, CK = 31;
constexpr float LN_EPS = 1e-5f;
constexpr float ALPHA = 1.189207115002721f;
constexpr int ECAP = 16384;
constexpr int MAXSLOT = 2 * M + NEXP * 256;

constexpr size_t MiB = 1u << 20;
constexpr size_t WS_CTL = 0, CTL_ZERO_BYTES = 64 * 1024;
constexpr size_t WS_W1T = 2 * MiB;
constexpr size_t WS_WOT = 7 * MiB;
constexpr size_t WS_WPGT = 9 * MiB;
constexpr size_t WS_WPPT = 11 * MiB;
constexpr size_t WS_WGUT = 12 * MiB;
constexpr size_t WS_WDT = 28 * MiB;
constexpr size_t WS_XN = 36 * MiB;
constexpr size_t WS_U = 68 * MiB, WS_CV = 84 * MiB, WS_BG = 100 * MiB;
constexpr size_t WS_Y = 68 * MiB;
constexpr size_t WS_YM = 68 * MiB;
constexpr size_t WS_AS = 132 * MiB;
constexpr size_t WS_PP = 164 * MiB;
constexpr size_t WS_H = 196 * MiB;
constexpr size_t WS_R = 215 * MiB;
constexpr size_t WS_PB = 215 * MiB;
constexpr size_t WS_TOK = 248 * MiB;
constexpr size_t WS_WSL = 249 * MiB;
constexpr size_t WS_TSL = 250 * MiB;
constexpr size_t WS_END = 256 * MiB;
static_assert(WS_YM + (size_t)MAXSLOT * 1024 * 2 <= WS_PP && WS_H + (size_t)MAXSLOT * 256 * 2 <= WS_R && WS_R + (size_t)M * D * 2 <= WS_TOK, "d_ws map");
constexpr int CW_CNT = 64;
constexpr int CW_BAR = 1024;

constexpr int RING_BYTES = 131072;
constexpr int LDSCTL_OFF = RING_BYTES;
constexpr int TAB_OFF = RING_BYTES + 512;
constexpr int ROUT_OFF = RING_BYTES + 1024;
constexpr int LDS_BYTES = 147456;
constexpr int NWAVES = 8, NTHR = 512;

__device__ __forceinline__ unsigned f2bf(float f) { unsigned u = __builtin_bit_cast(unsigned, f); return (u + 0x7fffu + ((u >> 16) & 1u)) >> 16; }
__device__ __forceinline__ unsigned pk2(float lo, float hi) { return f2bf(lo) | (f2bf(hi) << 16); }
__device__ __forceinline__ unsigned cvt_pk_bf16(float lo, float hi) { unsigned r; asm volatile("v_cvt_pk_bf16_f32 %0, %1, %2" : "=v"(r) : "v"(lo), "v"(hi)); return r; }
__device__ __forceinline__ float bf_lo(unsigned w) { return __builtin_bit_cast(float, w << 16); }
__device__ __forceinline__ float bf_hi(unsigned w) { return __builtin_bit_cast(float, w & 0xffff0000u); }
__device__ __forceinline__ float fast_sigmoid(float x) { return __builtin_amdgcn_rcpf(1.0f + __expf(-x)); }
__device__ __forceinline__ float wave_sum(float v) {
#pragma unroll
    for (int o = 1; o < 64; o <<= 1) v += __shfl_xor(v, o);
    return v;
}
#define LDS_WAIT() asm volatile("s_waitcnt lgkmcnt(0)" ::: "memory")
#define VM_WAIT() asm volatile("s_waitcnt vmcnt(0)" ::: "memory")

#define XB_TMO      128
#define XB_XCNT(j)  (256  + 64 * (j))
#define XB_XSUB(j)  (1280 + 64 * (j))
#define XB_XGEN(j)  (2304 + 64 * (j))
#define XB_TOP      3328
#define XB_TOPGEN   3392
#define XCD_BAR_WORDS 3456
#define XB_SPIN_CAP (1u << 18)
__device__ __forceinline__ unsigned xb_ld(unsigned* p)              { return __hip_atomic_load(p, __ATOMIC_RELAXED, __HIP_MEMORY_SCOPE_AGENT); }
__device__ __forceinline__ unsigned xb_add(unsigned* p, unsigned v) { return __hip_atomic_fetch_add(p, v, __ATOMIC_RELAXED, __HIP_MEMORY_SCOPE_AGENT); }
__device__ __forceinline__ unsigned xb_xcc_id() { return (unsigned)__builtin_amdgcn_s_getreg((3 << 11) | 20) & 0xFu; }
#define XB_SPIN(cond, bar) do { unsigned _sp = 0; while (cond) { __builtin_amdgcn_s_sleep(1); \
    if ((++_sp & 255u) == 0u) { if (xb_ld(&(bar)[XB_TMO])) break; if (_sp > XB_SPIN_CAP) { atomicAdd(&(bar)[XB_TMO], 1u); break; } } } } while (0)
struct XcdBarrier { unsigned* bar; unsigned x; volatile LAS unsigned* st; };
__device__ __forceinline__ XcdBarrier xcd_barrier_post(unsigned* bar, volatile LAS unsigned* st) {
    XcdBarrier b; b.bar = bar; b.x = xb_xcc_id(); b.st = st;
    if (threadIdx.x == 0) (void)xb_add(&bar[XB_XCNT(b.x)], 1u);
    return b;
}
__device__ __forceinline__ void xcd_barrier_complete(unsigned* bar, unsigned x, unsigned& nloc, unsigned& nx) {
    const unsigned G = gridDim.x * gridDim.y * gridDim.z;
    unsigned sum, cnt, mine, sp = 0u;
    for (;;) {
        sum = 0u; cnt = 0u; mine = 0u;
#pragma unroll
        for (unsigned j = 0; j < 16; ++j) { const unsigned c = xb_ld(&bar[XB_XCNT(j)]); sum += c; cnt += (c > 0u) ? 1u : 0u; mine = (j == x) ? c : mine; }
        if (sum == G) break;
        __builtin_amdgcn_s_sleep(1);
        if ((++sp & 255u) == 0u) { if (xb_ld(&bar[XB_TMO])) break; if (sp > XB_SPIN_CAP) { atomicAdd(&bar[XB_TMO], 1u); break; } }
    }
    nloc = mine > 0u ? mine : 1u; nx = cnt > 0u ? cnt : 1u;
}
__device__ __forceinline__ void xcd_barrier(const XcdBarrier& b) {
    asm volatile("s_waitcnt vmcnt(0)" ::: "memory");
    __syncthreads();
    if (threadIdx.x == 0) {
        unsigned* bar = b.bar;
        __builtin_amdgcn_s_waitcnt(0);
        unsigned nloc = b.st[0], nx = b.st[1];
        if (nloc == 0u) { xcd_barrier_complete(bar, b.x, nloc, nx); b.st[0] = nloc; b.st[1] = nx; }
        const unsigned old = xb_add(&bar[XB_XSUB(b.x)], 1u);
        const unsigned gen = old / nloc;
        if (old + 1u == (gen + 1u) * nloc) {
            __builtin_amdgcn_fence(__ATOMIC_RELEASE, "agent");
            asm volatile("s_waitcnt vmcnt(0)" ::: "memory");
            const unsigned og = xb_add(&bar[XB_TOP], 1u);
            const unsigned tg = og / nx;
            if (og + 1u == (tg + 1u) * nx) xb_add(&bar[XB_TOPGEN], 1u);
            else XB_SPIN(xb_ld(&bar[XB_TOPGEN]) == tg, bar);
            __builtin_amdgcn_fence(__ATOMIC_ACQUIRE, "agent");
            xb_add(&bar[XB_XGEN(b.x)], 1u);
            asm volatile("s_waitcnt vmcnt(0)" ::: "memory");
        } else {
            XB_SPIN(xb_ld(&bar[XB_XGEN(b.x)]) == gen, bar);
            __builtin_amdgcn_fence(__ATOMIC_ACQUIRE, "agent");
            asm volatile("s_waitcnt vmcnt(0)" ::: "memory");
        }
    }
    __syncthreads();
}

namespace pg8 {
constexpr int BM = 256, BK = 64, HALF = 128, HTB = HALF * BK * 2, NXCD = 8, WGM = 8;
__device__ __forceinline__ int lds_byte(int r, int c) { const int st = (r >> 4) * 2 + (c >> 5), rr = r & 15, cc = c & 31, ob = rr * 64 + cc * 2; return st * 1024 + (ob ^ (((ob >> 9) & 1) << 5)); }
__device__ __forceinline__ void stage_rc(int b, int& R, int& C) { const int st = b / 1024, sb = b % 1024, swz = sb ^ (((sb >> 9) & 1) << 5); R = (st >> 1) * 16 + swz / 64; C = (st & 1) * 32 + (swz % 64) / 2; }
__device__ __forceinline__ int perm32(int rho) { const int n = rho >> 4, i = rho & 15; return 8 * (i >> 2) + 4 * n + (i & 3); }

struct Unit { int pm, pn; const char* a; const char* b; const int* ridx; int nvalid; int e; };

struct DenseOrder {
    const char* A; const char* Bt; int K; int nM, nN, nwg, G, c;
    __device__ void init(const void* A_, const void* Bt_, int M_, int N_, int K_, int G_, int c_) { A = (const char*)A_; Bt = (const char*)Bt_; K = K_; nM = M_ / BM; nN = N_ / BM; nwg = nM * nN; G = G_; c = c_; }
    __device__ __forceinline__ bool next(int i, Unit& u) const {
        if (c < 0) return false;
        const long L = (long)i * G + c; if (L >= nwg) return false;
        int wgid = (int)L; { const int q = nwg / NXCD, r = nwg % NXCD, xcd = wgid % NXCD, off = wgid / NXCD; wgid = (xcd < r ? xcd * (q + 1) : r * (q + 1) + (xcd - r) * q) + off; }
        const int nig = WGM * nN, gid = wgid / nig, fm = gid * WGM, gsz = (nM - fm) < WGM ? (nM - fm) : WGM;
        u.pm = fm + ((wgid % nig) % gsz); u.pn = (wgid % nig) / gsz;
        u.a = A + (size_t)u.pm * BM * K * 2; u.b = Bt + (size_t)u.pn * BM * K * 2; u.ridx = nullptr; u.nvalid = 256; u.e = 0;
        return true;
    }
};

template <class Epi, class Sched, bool GATHER, bool ALIGN_EPI>
__device__ __forceinline__ void gemm_phase(LAS unsigned char* lds, const int K_, const Sched& S, const Epi& E) {
    int K = K_; asm volatile("" : "+s"(K));
    const int tid = threadIdx.x, wid = __builtin_amdgcn_readfirstlane(tid >> 6), lane = tid & 63, wr = wid >> 2, wc = wid & 3, fr = lane & 15, fq = lane >> 4;
    const int nt = K / BK;
    int Rst[2], Cst[2]; unsigned voffB[2];
#pragma unroll
    for (int i = 0; i < 2; ++i) { int R, C; stage_rc(tid * 16 + i * 8192, R, C); const int Rb = Epi::PERM ? ((R & ~31) + perm32(R & 31)) : R; Rst[i] = R; Cst[i] = C; voffB[i] = (unsigned)(Rb * K + C) * 2u; }
    const size_t kstep = (size_t)(BK * 2);
    const size_t hstep = (size_t)HALF * K * 2;
    const unsigned ldsw = (unsigned)wid * 1024u;
    const int aoff = lds_byte(wr * 64 + fr, fq * 8), boff = lds_byte(wc * 32 + fr, fq * 8);
#define PG8_SA(b, h) (((b) * 2 + (h)) * HTB)
#define PG8_SB(b, h) ((4 + (b) * 2 + (h)) * HTB)
#define PG8_STAGE(bufoff, gbase, voff) do { _Pragma("unroll") for (int _i = 0; _i < 2; ++_i) \
        __builtin_amdgcn_global_load_lds((const unsigned*)((const char*)(gbase) + (voff)[_i]), (LAS unsigned*)(lds + (bufoff) + ldsw + _i * 8192), 16, 0, 0); } while (0)
#define PG8_LDA(dst, b, h) do { _Pragma("unroll") for (int m = 0; m < 4; ++m) _Pragma("unroll") for (int k = 0; k < 2; ++k) dst[m][k] = *(const LAS bf16x8*)(lds + PG8_SA(b, h) + aoff + m * 2048 + k * 1024); } while (0)
#define PG8_LDB(dst, b, h) do { _Pragma("unroll") for (int n = 0; n < 2; ++n) _Pragma("unroll") for (int k = 0; k < 2; ++k) dst[n][k] = *(const LAS bf16x8*)(lds + PG8_SB(b, h) + boff + n * 2048 + k * 1024); } while (0)
#define PG8_MMA(ai, bj, At, Bt) do { __builtin_amdgcn_s_setprio(1); _Pragma("unroll") for (int m = 0; m < 4; ++m) _Pragma("unroll") for (int n = 0; n < 2; ++n) _Pragma("unroll") for (int k = 0; k < 2; ++k) \
        acc[ai][bj][m][n] = __builtin_amdgcn_mfma_f32_16x16x32_bf16(Bt[n][k], At[m][k], acc[ai][bj][m][n], 0, 0, 0); __builtin_amdgcn_s_setprio(0); } while (0)
#define PG8_WAIT_V(n) asm volatile("s_waitcnt vmcnt(" #n ")" ::: "memory")
#define PG8_WAIT_L(n) asm volatile("s_waitcnt lgkmcnt(" #n ")" ::: "memory")
#define PG8_BAR __builtin_amdgcn_s_barrier()
#define PG8_SCHED __builtin_amdgcn_sched_barrier(0)
#define PG8_VOFFA(dst, un) do { _Pragma("unroll") for (int _h = 0; _h < 2; ++_h) _Pragma("unroll") for (int _i = 0; _i < 2; ++_i) { const int _row = _h * HALF + Rst[_i]; \
        if constexpr (GATHER) { const int _tok = (_row < (un).nvalid) ? (un).ridx[_row] : 0; dst[_h][_i] = (unsigned)(_tok * K + Cst[_i]) * 2u; } \
        else dst[_h][_i] = (unsigned)(_row * K + Cst[_i]) * 2u; } } while (0)
    Unit cur, nxt; int ui = 0;
    if (!S.next(0, cur)) return;
    f32x4 acc[2][2][4][2];
#pragma unroll
    for (int a = 0; a < 2; ++a)
#pragma unroll
        for (int b = 0; b < 2; ++b)
#pragma unroll
            for (int m = 0; m < 4; ++m)
#pragma unroll
                for (int n = 0; n < 2; ++n) acc[a][b][m][n] = (f32x4){0.f, 0.f, 0.f, 0.f};
    bf16x8 At[4][2], B0[2][2], B1[2][2];
    unsigned voffA[2][2], nvoffA[2][2];
    PG8_VOFFA(voffA, cur);
#pragma unroll
    for (int h = 0; h < 2; ++h)
#pragma unroll
        for (int i = 0; i < 2; ++i) nvoffA[h][i] = voffA[h][i];
    const char* cA = cur.a; const char* cB = cur.b;
    PG8_STAGE(PG8_SB(0, 0), cB, voffB); PG8_STAGE(PG8_SB(0, 1), cB + hstep, voffB); PG8_STAGE(PG8_SA(0, 0), cA, voffA[0]); PG8_STAGE(PG8_SA(0, 1), cA, voffA[1]);
    if (wr == 1) PG8_BAR;
    PG8_WAIT_V(2); PG8_BAR;
    PG8_STAGE(PG8_SB(1, 0), cB + kstep, voffB); PG8_STAGE(PG8_SA(1, 0), cA + kstep, voffA[0]); PG8_STAGE(PG8_SB(1, 1), cB + hstep + kstep, voffB);
    PG8_WAIT_V(6); PG8_BAR;
    for (;;) {
        const bool has_next = S.next(ui + 1, nxt);
        const char* nA = has_next ? nxt.a : cA; const char* nB = has_next ? nxt.b : cB;
        if constexpr (GATHER) { if (has_next) PG8_VOFFA(nvoffA, nxt); }
        for (int t = 0; t < nt; t += 2) {
            const bool last = (t == nt - 2);
            const char* a1 = cA + (size_t)(t + 1) * kstep;
            const char* a2 = last ? nA : cA + (size_t)(t + 2) * kstep; const char* b2 = last ? nB : cB + (size_t)(t + 2) * kstep;
            const char* a3 = a2 + kstep; const char* b3 = b2 + kstep;
            unsigned vA2[2][2];
#pragma unroll
            for (int h = 0; h < 2; ++h)
#pragma unroll
                for (int i = 0; i < 2; ++i) vA2[h][i] = (GATHER && last) ? nvoffA[h][i] : voffA[h][i];
            PG8_LDB(B0, 0, 0); PG8_LDB(B1, 0, 1); PG8_SCHED; PG8_LDA(At, 0, 0); PG8_STAGE(PG8_SA(1, 1), a1, voffA[1]);
            PG8_WAIT_V(8); PG8_WAIT_L(0); PG8_BAR; PG8_MMA(0, 0, At, B0); PG8_MMA(0, 1, At, B1); PG8_BAR; PG8_SCHED;
            PG8_LDA(At, 0, 1); PG8_STAGE(PG8_SB(0, 0), b2, voffB); PG8_STAGE(PG8_SB(0, 1), b2 + hstep, voffB); PG8_STAGE(PG8_SA(0, 0), a2, vA2[0]);
            PG8_WAIT_V(8); PG8_WAIT_L(0); PG8_BAR; PG8_MMA(1, 0, At, B0); PG8_MMA(1, 1, At, B1); PG8_BAR; PG8_SCHED;
            PG8_LDB(B0, 1, 0); PG8_LDB(B1, 1, 1); PG8_SCHED; PG8_LDA(At, 1, 0); PG8_STAGE(PG8_SA(0, 1), a2, vA2[1]);
            PG8_WAIT_V(8); PG8_WAIT_L(0); PG8_BAR; PG8_MMA(0, 0, At, B0); PG8_MMA(0, 1, At, B1); PG8_BAR; PG8_SCHED;
            PG8_LDA(At, 1, 1); PG8_STAGE(PG8_SB(1, 0), b3, voffB); PG8_STAGE(PG8_SB(1, 1), b3 + hstep, voffB); PG8_STAGE(PG8_SA(1, 0), a3, vA2[0]);
            PG8_WAIT_V(8); PG8_WAIT_L(0); PG8_BAR; PG8_MMA(1, 0, At, B0); PG8_MMA(1, 1, At, B1); PG8_BAR; PG8_SCHED;
        }
        if constexpr (ALIGN_EPI) { if (wr == 0) PG8_BAR; }
        E(acc, cur, wr, wc, fr, fq);
        if (!has_next) break;
#pragma unroll
        for (int a = 0; a < 2; ++a)
#pragma unroll
            for (int b = 0; b < 2; ++b)
#pragma unroll
                for (int m = 0; m < 4; ++m)
#pragma unroll
                    for (int n = 0; n < 2; ++n) acc[a][b][m][n] = (f32x4){0.f, 0.f, 0.f, 0.f};
        cur = nxt; cA = nA; cB = nB; ++ui;
        if constexpr (GATHER) {
#pragma unroll
            for (int h = 0; h < 2; ++h)
#pragma unroll
                for (int i = 0; i < 2; ++i) voffA[h][i] = nvoffA[h][i];
        }
        if constexpr (ALIGN_EPI) { if (wr == 1) PG8_BAR; }
    }
    PG8_WAIT_V(0);
    if constexpr (!ALIGN_EPI) { if (wr == 0) PG8_BAR; }
    PG8_BAR;
#undef PG8_SA
#undef PG8_SB
#undef PG8_STAGE
#undef PG8_LDA
#undef PG8_LDB
#undef PG8_MMA
#undef PG8_WAIT_V
#undef PG8_WAIT_L
#undef PG8_BAR
#undef PG8_SCHED
#undef PG8_VOFFA
}


struct EpiBf16 {
    static constexpr bool PERM = true;
    bf16_t* O; int ldc;
    __device__ __forceinline__ void operator()(const f32x4 (&acc)[2][2][4][2], const Unit& u, int wr, int wc, int fr, int fq) const {
        const int row0 = u.pm * BM + wr * 64 + fr, col0 = u.pn * BM + wc * 32 + 8 * fq;
#pragma unroll
        for (int ai = 0; ai < 2; ++ai)
#pragma unroll
            for (int m = 0; m < 4; ++m) { bf16_t* rowp = O + (size_t)(row0 + ai * HALF + m * 16) * ldc + col0;
#pragma unroll
                for (int bj = 0; bj < 2; ++bj) { const f32x4 v0 = acc[ai][bj][m][0], v1 = acc[ai][bj][m][1];
                    u32x4 w; w.x = cvt_pk_bf16(v0[0], v0[1]); w.y = cvt_pk_bf16(v0[2], v0[3]); w.z = cvt_pk_bf16(v1[0], v1[1]); w.w = cvt_pk_bf16(v1[2], v1[3]);
                    *(u32x4*)(rowp + bj * HALF) = w; } }
    }
};

struct EpiIn {
    static constexpr bool PERM = true;
    bf16_t* U; bf16_t* CV; bf16_t* BG; const float* bias;
    __device__ __forceinline__ void operator()(const f32x4 (&acc)[2][2][4][2], const Unit& u, int wr, int wc, int fr, int fq) const {
        const int row0 = u.pm * BM + wr * 64 + fr, cc = wc * 32 + 8 * fq, pn = u.pn;
        const bool pair = pn < 8, glu = pn < 4;
        const int s0 = glu ? 128 * pn : pair ? 1536 + 128 * (pn - 4) : 1024 + 256 * (pn - 8), s1 = glu ? 512 + 128 * pn : pair ? 2048 + 128 * (pn - 4) : s0 + 128;
        bf16_t* O0 = glu ? U + 128 * pn : pair ? CV + 128 * (pn - 4) : BG + 256 * (pn - 8);
        bf16_t* O1 = pair ? O0 : O0 + HALF;
        f32x4 bv[2][2];
#pragma unroll
        for (int n = 0; n < 2; ++n) { bv[0][n] = *(const f32x4*)(bias + s0 + cc + 4 * n); bv[1][n] = *(const f32x4*)(bias + s1 + cc + 4 * n); }
#pragma unroll
        for (int ai = 0; ai < 2; ++ai)
#pragma unroll
            for (int m = 0; m < 4; ++m) { const size_t ro = (size_t)(row0 + ai * HALF + m * 16) * CW + cc; float a[8], g[8], o[8];
#pragma unroll
                for (int n = 0; n < 2; ++n)
#pragma unroll
                    for (int j = 0; j < 4; ++j) { a[4 * n + j] = acc[ai][0][m][n][j] + bv[0][n][j]; g[4 * n + j] = acc[ai][1][m][n][j] + bv[1][n][j]; const float gs = glu ? fast_sigmoid(g[4 * n + j]) : g[4 * n + j]; o[4 * n + j] = a[4 * n + j] * gs; }
                u32x4 w0, w1;
#pragma unroll
                for (int q = 0; q < 4; ++q) { const unsigned wo = cvt_pk_bf16(o[2 * q], o[2 * q + 1]), wa = cvt_pk_bf16(a[2 * q], a[2 * q + 1]), wg = cvt_pk_bf16(g[2 * q], g[2 * q + 1]); w0[q] = pair ? wo : wa; w1[q] = pair ? wo : wg; }
                *(u32x4*)(O0 + ro) = w0; *(u32x4*)(O1 + ro) = w1; }
    }
};

struct EpiY {
    static constexpr bool PERM = false;
    float* Y; const bf16_t* XN; const float* bias;
    __device__ __forceinline__ void operator()(const f32x4 (&acc)[2][2][4][2], const Unit& u, int wr, int wc, int fr, int fq) const {
        const int row0 = u.pm * BM + wr * 64 + fr, col0 = u.pn * BM + wc * 32 + 4 * fq;
        f32x4 bv[2][2];
#pragma unroll
        for (int bj = 0; bj < 2; ++bj)
#pragma unroll
            for (int n = 0; n < 2; ++n) bv[bj][n] = *(const f32x4*)(bias + col0 + bj * HALF + n * 16);
#pragma unroll
        for (int ai = 0; ai < 2; ++ai)
#pragma unroll
            for (int m = 0; m < 4; ++m) { const size_t off = (size_t)(row0 + ai * HALF + m * 16) * D + col0;
#pragma unroll
                for (int bj = 0; bj < 2; ++bj)
#pragma unroll
                    for (int n = 0; n < 2; ++n) { const u32x2 xw = *(const u32x2*)(XN + off + bj * HALF + n * 16);
                        f32x4 o = acc[ai][bj][m][n] + bv[bj][n]; o[0] += ALPHA * bf_lo(xw.x); o[1] += ALPHA * bf_hi(xw.x); o[2] += ALPHA * bf_lo(xw.y); o[3] += ALPHA * bf_hi(xw.y);
                        *(f32x4*)(Y + off + bj * HALF + n * 16) = o; } }
    }
};

struct EpiMoeUp {
    static constexpr bool PERM = true;
    bf16_t* H; const float* wsl; const int* tok;
    __device__ __forceinline__ void operator()(const f32x4 (&acc)[2][2][4][2], const Unit& u, int wr, int wc, int fr, int fq) const {
        const int rl0 = wr * 64 + fr, cc = wc * 32 + 8 * fq;
        const float* wrow = wsl + (u.ridx - tok);
#pragma unroll
        for (int ai = 0; ai < 2; ++ai)
#pragma unroll
            for (int m = 0; m < 4; ++m) { const int rl = rl0 + ai * HALF + m * 16; const float w = (rl < u.nvalid) ? wrow[rl] : 0.f;
                bf16_t* rowp = H + (size_t)(u.pm * BM + rl) * DEXP + 128 * u.pn + cc; float o[8];
#pragma unroll
                for (int n = 0; n < 2; ++n)
#pragma unroll
                    for (int j = 0; j < 4; ++j) { const float g = acc[ai][0][m][n][j], up = acc[ai][1][m][n][j]; o[4 * n + j] = g * fast_sigmoid(g) * up * w; }
                u32x4 wv; wv.x = cvt_pk_bf16(o[0], o[1]); wv.y = cvt_pk_bf16(o[2], o[3]); wv.z = cvt_pk_bf16(o[4], o[5]); wv.w = cvt_pk_bf16(o[6], o[7]);
                *(u32x4*)rowp = wv; }
    }
};

struct EpiGate {
    static constexpr bool PERM = false;
    float* V; const bf16_t* R; const bf16_t* PP; const float* bias;
    __device__ __forceinline__ void operator()(const f32x4 (&acc)[2][2][4][2], const Unit& u, int wr, int wc, int fr, int fq) const {
        const int row0 = u.pm * BM + wr * 64 + fr, col0 = u.pn * BM + wc * 32 + 4 * fq;
        f32x4 bv[2][2];
#pragma unroll
        for (int bj = 0; bj < 2; ++bj)
#pragma unroll
            for (int n = 0; n < 2; ++n) bv[bj][n] = *(const f32x4*)(bias + col0 + bj * HALF + n * 16);
#pragma unroll
        for (int ai = 0; ai < 2; ++ai)
#pragma unroll
            for (int m = 0; m < 4; ++m) { const size_t off = (size_t)(row0 + ai * HALF + m * 16) * D + col0;
#pragma unroll
                for (int bj = 0; bj < 2; ++bj)
#pragma unroll
                    for (int n = 0; n < 2; ++n) { const u32x2 rw = *(const u32x2*)(R + off + bj * HALF + n * 16), pw = *(const u32x2*)(PP + off + bj * HALF + n * 16);
                        const f32x4 z = acc[ai][bj][m][n] + bv[bj][n]; f32x4 o;
                        o[0] = bf_lo(rw.x) + fast_sigmoid(z[0]) * bf_lo(pw.x); o[1] = bf_hi(rw.x) + fast_sigmoid(z[1]) * bf_hi(pw.x);
                        o[2] = bf_lo(rw.y) + fast_sigmoid(z[2]) * bf_lo(pw.y); o[3] = bf_hi(rw.y) + fast_sigmoid(z[3]) * bf_hi(pw.y);
                        *(f32x4*)(V + off + bj * HALF + n * 16) = o; } }
    }
};
}

struct MoeUpOrder {
    const LAS int* tab; const char* X1; const char* Wgu; const int* tok; int G, c;
    __device__ __forceinline__ bool next(int i, pg8::Unit& u) const {
        const int L = i * G + c, TM = tab[32]; if (L >= TM * 2) return false;
        const int mt = L >> 1, pn = L & 1; int e = 0;
#pragma unroll
        for (int j = 1; j < 16; ++j) e += (mt >= tab[16 + j]) ? 1 : 0;
        const int lt = mt - tab[16 + e];
        u.pm = mt; u.pn = pn; u.e = e; u.a = X1; u.b = Wgu + ((size_t)e * 512 + (size_t)pn * 256) * D * 2; u.ridx = tok + e * ECAP + lt * 256; u.nvalid = tab[e] - lt * 256;
        return true;
    }
};
struct MoeDownOrder {
    const LAS int* tab; const char* H; const char* Wd; int G, c;
    __device__ __forceinline__ bool next(int i, pg8::Unit& u) const {
        const int L = i * G + c, TM = tab[32]; if (L >= TM * 4) return false;
        const int mt = L >> 2, pn = L & 3; int e = 0;
#pragma unroll
        for (int j = 1; j < 16; ++j) e += (mt >= tab[16 + j]) ? 1 : 0;
        u.pm = mt; u.pn = pn; u.e = e; u.a = H + (size_t)mt * 256 * DEXP * 2; u.b = Wd + ((size_t)e * 1024 + (size_t)pn * 256) * DEXP * 2; u.ridx = nullptr; u.nvalid = 256;
        return true;
    }
};

struct Args {
    const float* x; const float* p; const float* ln_in_g; const float* ln_in_b; const float* w_in; const float* b_in;
    const float* conf_dw_w; const float* conf_dw_b; const float* conf_ln_g; const float* conf_ln_b; const float* sc_w; const float* sc_b;
    const float* w_out; const float* b_out; const float* ln1_g; const float* ln1_b; const float* w_rg; const float* b_rg; const float* w_re; const float* b_re;
    const float* w_gate; const float* w_up; const float* w_down; const float* w_pg; const float* b_pg; const float* w_pp; const float* ln2_g; const float* ln2_b;
    float* out; unsigned char* ws; int ph_lo, ph_hi;
};

__device__ __forceinline__ void transpose_item(const float* src, int ldn, bf16_t* dst, int ldk, LAS float* scr, int lane) {
#pragma unroll 8
    for (int i = 0; i < 32; ++i) { const int kk = 2 * i + (lane >> 5); scr[kk * 33 + (lane & 31)] = src[(size_t)kk * ldn + (lane & 31)]; }
    LDS_WAIT(); asm volatile("" ::: "memory");
    const int c = lane & 7;
#pragma unroll
    for (int j = 0; j < 4; ++j) { const int n = (lane >> 3) + 8 * j; const LAS float* s = scr + (8 * c) * 33 + n;
        u32x4 o; o.x = pk2(s[0 * 33], s[1 * 33]); o.y = pk2(s[2 * 33], s[3 * 33]); o.z = pk2(s[4 * 33], s[5 * 33]); o.w = pk2(s[6 * 33], s[7 * 33]);
        *(u32x4*)(dst + (size_t)n * ldk + 8 * c) = o; }
    LDS_WAIT(); asm volatile("" ::: "memory");
}
__device__ __forceinline__ int win_src_col(int np) {
    const int pn = np >> 8, j = np & 255, bj = j >> 7, jj = j & 127;
    if (pn < 4) return (bj ? 512 : 0) + 128 * pn + jj;
    if (pn < 8) return (bj ? 2048 : 1536) + 128 * (pn - 4) + jj;
    return 1024 + 256 * (pn - 8) + j;
}

__device__ __forceinline__ void ln_row(const float* xrow, const float* g, const float* b, bf16_t* obf, float* of32, int lane) {
    const f32x4* xr = (const f32x4*)xrow + lane;
    f32x4 v[4]; float s = 0.f;
#pragma unroll
    for (int j = 0; j < 4; ++j) { v[j] = xr[64 * j]; s += (v[j].x + v[j].y) + (v[j].z + v[j].w); }
    const float mean = wave_sum(s) * (1.f / D); float s2 = 0.f;
#pragma unroll
    for (int j = 0; j < 4; ++j) { v[j] = v[j] - mean; s2 += (v[j].x * v[j].x + v[j].y * v[j].y) + (v[j].z * v[j].z + v[j].w * v[j].w); }
    const float rstd = 1.f / sqrtf(wave_sum(s2) * (1.f / D) + LN_EPS);
#pragma unroll
    for (int j = 0; j < 4; ++j) { const f32x4 gg = ((const f32x4*)g)[lane + 64 * j], bb = ((const f32x4*)b)[lane + 64 * j]; const f32x4 o = v[j] * rstd * gg + bb;
        if (obf) ((unsigned long long*)obf)[lane + 64 * j] = (unsigned long long)pk2(o.x, o.y) | ((unsigned long long)pk2(o.z, o.w) << 32);
        if (of32) ((f32x4*)of32)[lane + 64 * j] = o; }
}

__device__ __forceinline__ unsigned long long kload(int off) {
    unsigned long long v; const unsigned long long kp = (unsigned long long)__builtin_amdgcn_kernarg_segment_ptr();
    asm volatile("s_load_dwordx2 %0, %1, %2\n\ts_waitcnt lgkmcnt(0)" : "=s"(v) : "s"(kp), "i"(off) : "memory");
    return v;
}
#define KA(field) ((const float*)(const GAS float*)kload((int)__builtin_offsetof(Args, field)))
#define KOUT() ((float*)(GAS float*)kload((int)__builtin_offsetof(Args, out)))
#define KWS(T, off) ((T*)(GAS T*)(kload((int)__builtin_offsetof(Args, ws)) + (off)))

__global__ void __launch_bounds__(NTHR, 2) fwd_kernel(Args args) {
    extern __shared__ __attribute__((aligned(16))) unsigned char lds_raw[];
    LAS unsigned char* lds = (LAS unsigned char*)lds_raw;
    const int tid = threadIdx.x, lane = tid & 63, wave = __builtin_amdgcn_readfirstlane(tid >> 6);
    const int G = gridDim.x, bx = blockIdx.x;
    const int vcu = (G % 8 == 0) ? (bx % 8) * (G / 8) + bx / 8 : bx;
    unsigned* ctl = KWS(unsigned, WS_CTL);
    LAS int* tab = (LAS int*)(lds + TAB_OFF);

    for (int u = tid; u < (LDS_BYTES - LDSCTL_OFF) / 4; u += NTHR) ((LAS unsigned*)(lds + LDSCTL_OFF))[u] = 0u;
    __syncthreads();
    const int lo = args.ph_lo, hi = args.ph_hi;
    const bool one_launch = (hi - lo) > 1;
    XcdBarrier bar; bar.bar = ctl + CW_BAR; bar.x = 0; bar.st = nullptr;
    if (one_launch) bar = xcd_barrier_post(ctl + CW_BAR, (volatile LAS unsigned*)(lds + LDSCTL_OFF) + 8);
#ifndef PHASE_MASK
#define PHASE_MASK 0x3ff
#endif
#define IN(k) (((PHASE_MASK >> (k)) & 1) && lo <= (k) && (k) < hi)
#define SEAM(k) do { if (IN(k) && IN((k) + 1)) xcd_barrier(bar); } while (0)

    if (IN(0)) {
        const float* a_w_in = KA(w_in); const float* a_w_out = KA(w_out); const float* a_w_pg = KA(w_pg); const float* a_w_pp = KA(w_pp); const float* a_w_gate = KA(w_gate); const float* a_w_up = KA(w_up); const float* a_w_down = KA(w_down);
        const float* a_x = KA(x); const float* a_p = KA(p); const float* a_g = KA(ln_in_g); const float* a_b = KA(ln_in_b);
        bf16_t* W1T = KWS(bf16_t, WS_W1T); bf16_t* WOT = KWS(bf16_t, WS_WOT); bf16_t* WPGT = KWS(bf16_t, WS_WPGT); bf16_t* WPPT = KWS(bf16_t, WS_WPPT); bf16_t* WGUT = KWS(bf16_t, WS_WGUT); bf16_t* WDT = KWS(bf16_t, WS_WDT);
        bf16_t* XN = KWS(bf16_t, WS_XN); bf16_t* PB = KWS(bf16_t, WS_PB);
        LAS float* scr = (LAS float*)(lds + wave * 16384);
        const int gw = vcu * NWAVES + wave, NGW = G * NWAVES;
        constexpr int I_IN = 16 * 80, I_O = 16 * 32, I_PG = 16 * 32, I_PP = 4 * 32, I_GU = 16 * 2 * 16 * 8, I_D = 16 * 4 * 32;
        constexpr int NITEMS = I_IN + I_O + I_PG + I_PP + I_GU + I_D;
        for (int it = gw; it < NITEMS; it += NGW) {
            int r = it;
            if (r < I_IN) { const int kb = r / 80, nb = r % 80, np = nb * 32; transpose_item(a_w_in + (size_t)kb * 64 * DIN + win_src_col(np), DIN, W1T + (size_t)np * D + kb * 64, D, scr, lane); continue; } r -= I_IN;
            if (r < I_O) { const int kb = r / 32, nb = r % 32; transpose_item(a_w_out + (size_t)kb * 64 * D + nb * 32, D, WOT + (size_t)nb * 32 * D + kb * 64, D, scr, lane); continue; } r -= I_O;
            if (r < I_PG) { const int kb = r / 32, nb = r % 32; transpose_item(a_w_pg + (size_t)kb * 64 * D + nb * 32, D, WPGT + (size_t)nb * 32 * D + kb * 64, D, scr, lane); continue; } r -= I_PG;
            if (r < I_PP) { const int kb = r / 32, nb = r % 32; transpose_item(a_w_pp + (size_t)kb * 64 * D + nb * 32, D, WPPT + (size_t)nb * 32 * DPLE + kb * 64, DPLE, scr, lane); continue; } r -= I_PP;
            if (r < I_GU) { const int e = r / 256, q = r % 256, s = q / 128, q2 = q % 128, kb = q2 / 8, nb = q2 % 8;
                const float* W = (s ? a_w_up : a_w_gate) + (size_t)e * D * DEXP; const int f0 = nb * 32, p = f0 >> 7, jj = f0 & 127;
                transpose_item(W + (size_t)kb * 64 * DEXP + f0, DEXP, WGUT + ((size_t)e * 512 + 256 * p + 128 * s + jj) * D + kb * 64, D, scr, lane); continue; } r -= I_GU;
            { const int e = r / 128, q = r % 128, kb = q / 32, nb = q % 32;
                transpose_item(a_w_down + (size_t)e * DEXP * D + (size_t)kb * 64 * D + nb * 32, D, WDT + ((size_t)e * 1024 + nb * 32) * DEXP + kb * 64, DEXP, scr, lane); }
        }
        for (int m = gw; m < M; m += NGW) ln_row(a_x + (size_t)m * D, a_g, a_b, XN + (size_t)m * D, nullptr, lane);
        for (int m = gw; m < M; m += NGW) { const f32x4 v = ((const f32x4*)(a_p + (size_t)m * DPLE))[lane]; ((u32x2*)(PB + (size_t)m * DPLE))[lane] = (u32x2){pk2(v.x, v.y), pk2(v.z, v.w)}; }
    }
    SEAM(0);


#define BUILD_TAB() do { __syncthreads(); if (tid < 16) tab[tid] = (int)__hip_atomic_load(ctl + CW_CNT + tid, __ATOMIC_RELAXED, __HIP_MEMORY_SCOPE_AGENT); __syncthreads(); \
        if (tid == 0) { int a_ = 0; for (int e_ = 0; e_ < 16; ++e_) { tab[16 + e_] = a_; a_ += (tab[e_] + 255) >> 8; } tab[32] = a_; } __syncthreads(); } while (0)

    if (IN(1)) {
        bf16_t* XN = KWS(bf16_t, WS_XN); bf16_t* W1T = KWS(bf16_t, WS_W1T); bf16_t* Ub = KWS(bf16_t, WS_U); bf16_t* CVb = KWS(bf16_t, WS_CV); bf16_t* BGb = KWS(bf16_t, WS_BG);
        bf16_t* PB = KWS(bf16_t, WS_PB); bf16_t* WPPT = KWS(bf16_t, WS_WPPT); bf16_t* PP = KWS(bf16_t, WS_PP); const float* a_b_in = KA(b_in);
        { pg8::DenseOrder S; S.init(XN, W1T, M, DIN, D, G, bx); pg8::EpiIn E{Ub, CVb, BGb, a_b_in};
          pg8::gemm_phase<pg8::EpiIn, pg8::DenseOrder, false, true>(lds, D, S, E); }
        { pg8::DenseOrder S; const int half = G / 2; S.init(PB, WPPT, M, D, DPLE, G - half, bx >= half ? bx - half : -1); pg8::EpiBf16 E{PP, D};
          pg8::gemm_phase<pg8::EpiBf16, pg8::DenseOrder, false, true>(lds, DPLE, S, E); }
    }
    SEAM(1);

    if (IN(2)) {
        bf16_t* Ub = KWS(bf16_t, WS_U); bf16_t* CVb = KWS(bf16_t, WS_CV); bf16_t* BGb = KWS(bf16_t, WS_BG); bf16_t* AS = KWS(bf16_t, WS_AS);
        const float* a_cdw = KA(conf_dw_w); const float* a_cdb = KA(conf_dw_b); const float* a_clg = KA(conf_ln_g); const float* a_clb = KA(conf_ln_b); const float* a_scw = KA(sc_w); const float* a_scb = KA(sc_b);
        const int cp = tid & 255, th = __builtin_amdgcn_readfirstlane(tid >> 8), w4 = wave & 3;
        const unsigned* U32 = (const unsigned*)Ub; const unsigned* CV32 = (const unsigned*)CVb; const unsigned* BG32 = (const unsigned*)BGb; unsigned* AS32 = (unsigned*)AS;
        LAS f32x2* red = (LAS f32x2*)lds;
        const f32x2 cb = *(const f32x2*)(a_cdb + 2 * cp), lg = *(const f32x2*)(a_clg + 2 * cp), lb = *(const f32x2*)(a_clb + 2 * cp);
        const f32x2 sb = *(const f32x2*)(a_scb + 2 * cp), sw0 = *(const f32x2*)(a_scw + 2 * cp), sw1 = *(const f32x2*)(a_scw + CW + 2 * cp), sw2 = *(const f32x2*)(a_scw + 2 * CW + 2 * cp);
        for (int item = bx; item < M / 32; item += G) {
            const int t0 = item * 32 + th * 16, tseq = t0 & (SEQ - 1);
            float in0[46], in1[46];
#pragma unroll
            for (int i = 0; i < 46; ++i) { const int ts = tseq - 30 + i; const int row = (ts >= 0) ? (t0 - 30 + i) : t0; unsigned w = U32[(size_t)row * 256 + cp]; w = (ts >= 0) ? w : 0u; in0[i] = bf_lo(w); in1[i] = bf_hi(w); }
            float a0[16], a1[16];
#pragma unroll
            for (int j = 0; j < 16; ++j) { a0[j] = cb.x; a1[j] = cb.y; }
#pragma unroll
            for (int k = 0; k < CK; ++k) { const f32x2 wk = *(const f32x2*)(a_cdw + k * CW + 2 * cp);
#pragma unroll
                for (int j = 0; j < 16; ++j) { a0[j] += wk.x * in0[j + k]; a1[j] += wk.y * in1[j + k]; } }
#pragma unroll
            for (int j = 0; j < 16; ++j) { const float s1 = wave_sum(a0[j] + a1[j]), s2 = wave_sum(a0[j] * a0[j] + a1[j] * a1[j]); if (lane == 0) red[(th * 16 + j) * 4 + w4] = (f32x2){s1, s2}; }
            __syncthreads();
#pragma unroll
            for (int j = 0; j < 16; ++j) { const LAS f32x2* r4 = red + (th * 16 + j) * 4; const f32x2 p0 = r4[0], p1 = r4[1], p2 = r4[2], p3 = r4[3];
                const float mean = ((p0.x + p1.x) + (p2.x + p3.x)) * (1.f / CW), ex2 = ((p0.y + p1.y) + (p2.y + p3.y)) * (1.f / CW);
                const float rstd = 1.f / sqrtf(fmaxf(ex2 - mean * mean, 0.f) + LN_EPS);
                const float y0 = (a0[j] - mean) * rstd * lg.x + lb.x, y1 = (a1[j] - mean) * rstd * lg.y + lb.y;
                AS32[(size_t)(t0 + j) * 512 + cp] = cvt_pk_bf16(y0 * fast_sigmoid(y0), y1 * fast_sigmoid(y1)); }
            float c0[18], c1[18];
#pragma unroll
            for (int i = 0; i < 18; ++i) { const int ts = tseq - 2 + i; const int row = (ts >= 0) ? (t0 - 2 + i) : t0; unsigned w = CV32[(size_t)row * 256 + cp]; w = (ts >= 0) ? w : 0u; c0[i] = bf_lo(w); c1[i] = bf_hi(w); }
#pragma unroll
            for (int j = 0; j < 16; ++j) { const unsigned bw = BG32[(size_t)(t0 + j) * 256 + cp];
                const float s0 = bf_lo(bw) * (sw0.x * c0[j] + sw1.x * c0[j + 1] + sw2.x * c0[j + 2] + sb.x), s1 = bf_hi(bw) * (sw0.y * c1[j] + sw1.y * c1[j + 1] + sw2.y * c1[j + 2] + sb.y);
                AS32[(size_t)(t0 + j) * 512 + 256 + cp] = cvt_pk_bf16(s0, s1); }
            __syncthreads();
        }
    }
    SEAM(2);

    if (IN(3)) { bf16_t* AS = KWS(bf16_t, WS_AS); bf16_t* WOT = KWS(bf16_t, WS_WOT); float* Y = KWS(float, WS_Y); bf16_t* XN = KWS(bf16_t, WS_XN); const float* a_b_out = KA(b_out);
        pg8::DenseOrder S; S.init(AS, WOT, M, D, D, G, bx); pg8::EpiY E{Y, XN, a_b_out};
        pg8::gemm_phase<pg8::EpiY, pg8::DenseOrder, false, false>(lds, D, S, E); }
    SEAM(3);

    if (IN(4)) {
        const float* a_w_rg = KA(w_rg); const float* a_w_re = KA(w_re); const float* a_ln1_g = KA(ln1_g); const float* a_ln1_b = KA(ln1_b); const float* a_b_rg = KA(b_rg); const float* a_b_re = KA(b_re);
        float* Y = KWS(float, WS_Y); bf16_t* X1 = KWS(bf16_t, WS_XN); int* TOK = KWS(int, WS_TOK); float* WSL = KWS(float, WS_WSL); unsigned* TSL = KWS(unsigned, WS_TSL);
        LAS float* wl = (LAS float*)lds;
        for (int i = tid; i < 4096; i += NTHR) wl[(i & 3) * 1024 + (i >> 2)] = a_w_rg[i];
        for (int i = tid; i < 16384; i += NTHR) wl[(4 + (i & 15)) * 1024 + (i >> 4)] = a_w_re[i];
        LAS int* lcnt = (LAS int*)(lds + ROUT_OFF); LAS int* gbase = lcnt + 16; LAS int* rec = lcnt + 32;
        if (tid < 16) lcnt[tid] = 0;
        __syncthreads();
        f32x4 g1[4], b1[4];
#pragma unroll
        for (int j = 0; j < 4; ++j) { g1[j] = ((const f32x4*)a_ln1_g)[lane + 64 * j]; b1[j] = ((const f32x4*)a_ln1_b)[lane + 64 * j]; }
        float brg[4], bre[16];
#pragma unroll
        for (int j = 0; j < 4; ++j) brg[j] = a_b_rg[j];
#pragma unroll
        for (int j = 0; j < 16; ++j) bre[j] = a_b_re[j];
        for (int item = bx; item < M / 64; item += G) {
            for (int i = 0; i < 8; ++i) {
                const int rl = wave * 8 + i, row = item * 64 + rl;
                const f32x4* yr = (const f32x4*)(Y + (size_t)row * D) + lane;
                f32x4 v[4]; float s = 0.f;
#pragma unroll
                for (int j = 0; j < 4; ++j) { v[j] = yr[64 * j]; s += (v[j].x + v[j].y) + (v[j].z + v[j].w); }
                const float mean = wave_sum(s) * (1.f / D); float s2 = 0.f;
#pragma unroll
                for (int j = 0; j < 4; ++j) { v[j] = v[j] - mean; s2 += (v[j].x * v[j].x + v[j].y * v[j].y) + (v[j].z * v[j].z + v[j].w * v[j].w); }
                const float rstd = 1.f / sqrtf(wave_sum(s2) * (1.f / D) + LN_EPS);
#pragma unroll
                for (int j = 0; j < 4; ++j) { v[j] = v[j] * rstd * g1[j] + b1[j];
                    ((unsigned long long*)(X1 + (size_t)row * D))[lane + 64 * j] = (unsigned long long)pk2(v[j].x, v[j].y) | ((unsigned long long)pk2(v[j].z, v[j].w) << 32); }
                float lgt[20];
#pragma unroll
                for (int e = 0; e < 20; ++e) { float a = 0.f;
#pragma unroll
                    for (int j = 0; j < 4; ++j) { const f32x4 w = *(const LAS f32x4*)(wl + e * 1024 + 4 * lane + 256 * j); a += (v[j].x * w.x + v[j].y * w.y) + (v[j].z * w.z + v[j].w * w.w); }
                    lgt[e] = wave_sum(a); }
                float gl[4];
#pragma unroll
                for (int j = 0; j < 4; ++j) gl[j] = lgt[j] + brg[j];
                int gi = 0; float gm = gl[0];
#pragma unroll
                for (int j = 1; j < 4; ++j) if (gl[j] > gm) { gm = gl[j]; gi = j; }
                float gs = 0.f;
#pragma unroll
                for (int j = 0; j < 4; ++j) gs += __expf(gl[j] - gm);
                const float gp = 1.f / gs;
                float el[4];
#pragma unroll
                for (int k = 0; k < 4; ++k) { const float x0 = lgt[4 + k] + bre[k], x1 = lgt[8 + k] + bre[4 + k], x2 = lgt[12 + k] + bre[8 + k], x3 = lgt[16 + k] + bre[12 + k]; el[k] = gi == 0 ? x0 : gi == 1 ? x1 : gi == 2 ? x2 : x3; }
                int i1 = 0; float m1 = el[0];
#pragma unroll
                for (int k = 1; k < 4; ++k) if (el[k] > m1) { m1 = el[k]; i1 = k; }
                int i2 = -1; float m2 = -3.0e38f;
#pragma unroll
                for (int k = 0; k < 4; ++k) if (k != i1 && el[k] > m2) { m2 = el[k]; i2 = k; }
                const float dd = __expf(m2 - m1), w1 = gp / (1.f + dd), w2 = gp * dd / (1.f + dd);
                if (lane == 0) { const int e0 = gi * 4 + i1, e1 = gi * 4 + i2;
                    const int lp0 = __hip_atomic_fetch_add((int*)(lcnt + e0), 1, __ATOMIC_RELAXED, __HIP_MEMORY_SCOPE_WORKGROUP), lp1 = __hip_atomic_fetch_add((int*)(lcnt + e1), 1, __ATOMIC_RELAXED, __HIP_MEMORY_SCOPE_WORKGROUP);
                    rec[rl * 6 + 0] = e0; rec[rl * 6 + 1] = e1; rec[rl * 6 + 2] = lp0; rec[rl * 6 + 3] = lp1; rec[rl * 6 + 4] = __builtin_bit_cast(int, w1); rec[rl * 6 + 5] = __builtin_bit_cast(int, w2); }
            }
            __syncthreads();
            if (tid < 16) gbase[tid] = (int)__hip_atomic_fetch_add(ctl + CW_CNT + tid, (unsigned)lcnt[tid], __ATOMIC_RELAXED, __HIP_MEMORY_SCOPE_AGENT);
            __syncthreads();
            if (tid < 128) { const int rl = tid >> 1, k = tid & 1, e = rec[rl * 6 + k], pos = gbase[e] + rec[rl * 6 + 2 + k], row = item * 64 + rl;
                TOK[e * ECAP + pos] = row; WSL[e * ECAP + pos] = __builtin_bit_cast(float, rec[rl * 6 + 4 + k]); TSL[row * 2 + k] = ((unsigned)e << 16) | (unsigned)pos; }
            __syncthreads();
            if (tid < 16) lcnt[tid] = 0;
            __syncthreads();
        }
    }
    SEAM(4);

    if (IN(5)) { BUILD_TAB(); bf16_t* X1 = KWS(bf16_t, WS_XN); bf16_t* WGUT = KWS(bf16_t, WS_WGUT); int* TOK = KWS(int, WS_TOK); float* WSL = KWS(float, WS_WSL); bf16_t* Hb = KWS(bf16_t, WS_H);
        MoeUpOrder S{tab, (const char*)X1, (const char*)WGUT, TOK, G, bx}; pg8::EpiMoeUp E{Hb, WSL, TOK};
        pg8::gemm_phase<pg8::EpiMoeUp, MoeUpOrder, true, true>(lds, D, S, E); }
    SEAM(5);

    if (IN(6)) { BUILD_TAB(); bf16_t* Hb = KWS(bf16_t, WS_H); bf16_t* WDT = KWS(bf16_t, WS_WDT); bf16_t* YM = KWS(bf16_t, WS_YM);
        MoeDownOrder S{tab, (const char*)Hb, (const char*)WDT, G, bx}; pg8::EpiBf16 E{YM, D};
        pg8::gemm_phase<pg8::EpiBf16, MoeDownOrder, false, true>(lds, DEXP, S, E); }
    SEAM(6);

    if (IN(7)) { BUILD_TAB(); unsigned* TSL = KWS(unsigned, WS_TSL); bf16_t* X1 = KWS(bf16_t, WS_XN); bf16_t* YM = KWS(bf16_t, WS_YM); bf16_t* Rb = KWS(bf16_t, WS_R);
        const int gw = vcu * NWAVES + wave, NGW = G * NWAVES;
        for (int row = gw; row < M; row += NGW) {
            const unsigned u0 = TSL[row * 2], u1 = TSL[row * 2 + 1];
            const size_t s0 = (size_t)tab[16 + (u0 >> 16)] * 256 + (u0 & 0xffffu), s1 = (size_t)tab[16 + (u1 >> 16)] * 256 + (u1 & 0xffffu);
#pragma unroll
            for (int j = 0; j < 2; ++j) { const int c = 8 * lane + 512 * j;
                const u32x4 xv = *(const u32x4*)(X1 + (size_t)row * D + c), av = *(const u32x4*)(YM + s0 * D + c), bv = *(const u32x4*)(YM + s1 * D + c); u32x4 o;
#pragma unroll
                for (int q = 0; q < 4; ++q) o[q] = pk2(ALPHA * bf_lo(xv[q]) + bf_lo(av[q]) + bf_lo(bv[q]), ALPHA * bf_hi(xv[q]) + bf_hi(av[q]) + bf_hi(bv[q]));
                *(u32x4*)(Rb + (size_t)row * D + c) = o; }
        }
    }
    SEAM(7);

    if (IN(8)) { bf16_t* Rb = KWS(bf16_t, WS_R); bf16_t* WPGT = KWS(bf16_t, WS_WPGT); bf16_t* PP = KWS(bf16_t, WS_PP); float* a_out = KOUT(); const float* a_b_pg = KA(b_pg);
        pg8::DenseOrder S; S.init(Rb, WPGT, M, D, D, G, bx); pg8::EpiGate E{a_out, Rb, PP, a_b_pg};
        pg8::gemm_phase<pg8::EpiGate, pg8::DenseOrder, false, false>(lds, D, S, E); }
    SEAM(8);

    if (IN(9)) { const int gw = vcu * NWAVES + wave, NGW = G * NWAVES; float* a_out = KOUT(); const float* a_g2 = KA(ln2_g); const float* a_b2 = KA(ln2_b);
        for (int row = gw; row < M; row += NGW) ln_row(a_out + (size_t)row * D, a_g2, a_b2, nullptr, a_out + (size_t)row * D, lane); }
#undef IN
#undef SEAM
}

#ifndef MK_N_LAUNCHES
#define MK_N_LAUNCHES 1
#endif
constexpr int N_PHASES = 10;
extern "C" void kernel_launch(void* const* d_in, const int* in_sizes, int n_in, void* d_out, int out_size, void* d_ws, size_t ws_size, hipStream_t stream) {
    static int grid = 0;
    if (grid == 0) {
        if (n_in != 28 || in_sizes[0] != M * D || out_size != M * D || ws_size < WS_END) { fprintf(stderr, "kernel_launch: unexpected shapes (n_in %d, in0 %d, out %d, ws %zu); nothing launched\n", n_in, n_in > 0 ? in_sizes[0] : -1, out_size, ws_size); grid = -1; return; }
        int dev = 0, cus = 0, per_cu = 0;
        if (hipGetDevice(&dev) != hipSuccess || hipDeviceGetAttribute(&cus, hipDeviceAttributeMultiprocessorCount, dev) != hipSuccess) { grid = -1; return; }
        if (hipFuncSetAttribute((const void*)fwd_kernel, hipFuncAttributeMaxDynamicSharedMemorySize, LDS_BYTES) != hipSuccess) { fprintf(stderr, "kernel_launch: hipFuncSetAttribute failed\n"); grid = -1; return; }
        if (hipOccupancyMaxActiveBlocksPerMultiprocessor(&per_cu, (const void*)fwd_kernel, NTHR, LDS_BYTES) != hipSuccess || per_cu < 1) { fprintf(stderr, "kernel_launch: occupancy query reports %d workgroups per CU; nothing launched\n", per_cu); (void)hipGetLastError(); grid = -1; return; }
        grid = cus;
    }
    if (grid < 0) return;
    (void)hipMemsetAsync((char*)d_ws + WS_CTL, 0, CTL_ZERO_BYTES, stream);
    Args a{};
    const float** ap = (const float**)&a;
    for (int i = 0; i < 28; ++i) ap[i] = (const float*)d_in[i];
    a.out = (float*)d_out; a.ws = (unsigned char*)d_ws;
    if (MK_N_LAUNCHES == 1) { a.ph_lo = 0; a.ph_hi = N_PHASES; hipLaunchKernelGGL(fwd_kernel, dim3(grid), dim3(NTHR), LDS_BYTES, stream, a); }
    else for (int li = 0; li < N_PHASES; ++li) { a.ph_lo = li; a.ph_hi = li + 1; hipLaunchKernelGGL(fwd_kernel, dim3(grid), dim3(NTHR), LDS_BYTES, stream, a); }
}
```
